# Optimizing an MI355X kernel written in HIP

```python
import jax, jax.numpy as jnp
from jax import lax
import numpy as np

D_MODEL = 1024
BATCH = 8
SEQ = 2048
DEPTH = 2

HEAD_DIM = 64
ATTN_WIDTH = D_MODEL // 2
ATTN_HEADS = ATTN_WIDTH // HEAD_DIM
CONV_WIDTH = D_MODEL // 4
CONV_HEADS = CONV_WIDTH // HEAD_DIM
CONV_K = 3
POOL_WIDTH = D_MODEL // 4
POOL_WINDOWS = (2, 4, 8, 16)
POOL_GROUPS = len(POOL_WINDOWS)
POOL_GROUP_DIM = POOL_WIDTH // POOL_GROUPS
MIX_WIDTH = ATTN_WIDTH + CONV_WIDTH + POOL_WIDTH
IN_WIDTH = 3 * ATTN_WIDTH + 3 * CONV_WIDTH + POOL_WIDTH
MOBA_BLOCK = 256
MOBA_TOPK = 3
Q_CHUNK = 32
D_FF = -(-(8 * D_MODEL) // (3 * 256)) * 256
NORM_EPS = 1e-6

kernel_name = "hybrid_moba_conv_pool_block"


def rms_norm(x, g):
    xf = x.astype(jnp.float32)
    y = xf * lax.rsqrt(jnp.mean(xf * xf, axis=-1, keepdims=True) + NORM_EPS)
    return (y * g.astype(jnp.float32)).astype(x.dtype)


def alibi_slopes(n_heads):
    return jnp.asarray(2.0 ** (-8.0 * np.arange(1, n_heads + 1) / n_heads), dtype=jnp.float32)


def moba_attention(q, k, v):
    B, H, S, Dh = q.shape
    nb = -(-S // MOBA_BLOCK)
    s_pad = nb * MOBA_BLOCK
    topk = min(MOBA_TOPK, nb)
    pad = ((0, 0), (0, 0), (0, s_pad - S), (0, 0))
    kp = jnp.pad(k, pad)
    vp = jnp.pad(v, pad)
    k_blocks = kp.reshape(B, H, nb, MOBA_BLOCK, Dh)
    v_blocks = vp.reshape(B, H, nb, MOBA_BLOCK, Dh)
    k_mean = jnp.mean(k_blocks.astype(jnp.float32), axis=3)
    slopes = alibi_slopes(H)
    scale = Dh ** -0.5
    b_idx = jnp.arange(B)[:, None, None]
    h_idx = jnp.arange(H)[None, :, None]
    blk_pos = jnp.arange(MOBA_BLOCK)
    neg_inf = jnp.float32(-jnp.inf)

    def chunk(start):
        qc = lax.dynamic_slice_in_dim(q, start, Q_CHUNK, axis=2).astype(jnp.float32)
        t = start + jnp.arange(Q_CHUNK)
        cur = start // MOBA_BLOCK
        gate = jnp.einsum('bhqd,bhnd->bhqn', qc, k_mean)
        gate = jnp.where(jnp.arange(nb) < cur, gate, neg_inf)
        _, gidx = lax.top_k(gate, topk)
        valid = jnp.arange(topk) < cur
        own_start = cur * MOBA_BLOCK
        k_own = lax.dynamic_slice_in_dim(kp, own_start, MOBA_BLOCK, axis=2)
        v_own = lax.dynamic_slice_in_dim(vp, own_start, MOBA_BLOCK, axis=2)
        s_own = own_start + blk_pos
        dist_own = (t[:, None] - s_own[None, :]).astype(jnp.float32)
        logit_own = (jnp.einsum('bhqd,bhkd->bhqk', qc, k_own) * scale
                     - slopes[:, None, None] * dist_own)
        logit_own = jnp.where(dist_own >= 0, logit_own, neg_inf)
        flat_idx = gidx.reshape(B, H, Q_CHUNK * topk)
        k_sel = k_blocks[b_idx, h_idx, flat_idx].reshape(B, H, Q_CHUNK, topk, MOBA_BLOCK, Dh)
        v_sel = v_blocks[b_idx, h_idx, flat_idx].reshape(B, H, Q_CHUNK, topk, MOBA_BLOCK, Dh)
        s_sel = gidx[..., None] * MOBA_BLOCK + blk_pos
        dist_sel = (t[None, None, :, None, None] - s_sel).astype(jnp.float32)
        logit_sel = (jnp.einsum('bhqd,bhqnkd->bhqnk', qc, k_sel) * scale
                     - slopes[None, :, None, None, None] * dist_sel)
        logit_sel = jnp.where(valid[:, None], logit_sel, neg_inf)
        logits = jnp.concatenate(
            [logit_own, logit_sel.reshape(B, H, Q_CHUNK, topk * MOBA_BLOCK)], axis=-1)
        p = jax.nn.softmax(logits, axis=-1)
        p_own = p[..., :MOBA_BLOCK]
        p_sel = p[..., MOBA_BLOCK:].reshape(B, H, Q_CHUNK, topk, MOBA_BLOCK)
        o = (jnp.einsum('bhqk,bhkd->bhqd', p_own, v_own)
             + jnp.einsum('bhqnk,bhqnkd->bhqd', p_sel, v_sel))
        return o.astype(q.dtype)

    starts = jnp.arange(S // Q_CHUNK) * Q_CHUNK
    out = lax.map(chunk, starts)
    return out.transpose(1, 0, 3, 2, 4).reshape(B, S, H * Dh)


def short_conv_mixer(h, b_gate, c_gate, conv_w):
    S = h.shape[1]
    u = c_gate * h
    up = jnp.pad(u, ((0, 0), (CONV_K - 1, 0), (0, 0)))
    conv = up[:, 0:S] * conv_w[0]
    for j in range(1, CONV_K):
        conv = conv + up[:, j:j + S] * conv_w[j]
    return b_gate * conv


def pool_mixer(u, pool_w, pool_scale):
    B, S, _ = u.shape
    uf = u.astype(jnp.float32).reshape(B, S, POOL_GROUPS, POOL_GROUP_DIM)
    cs = jnp.cumsum(uf, axis=1)
    t = jnp.arange(1, S + 1, dtype=jnp.float32)
    outs = []
    for g, w in enumerate(POOL_WINDOWS):
        csg = cs[:, :, g]
        lag = jnp.pad(csg, ((0, 0), (w, 0), (0, 0)))[:, :S]
        cnt = jnp.minimum(t, jnp.float32(w))[None, :, None]
        outs.append((csg - lag) / cnt - uf[:, :, g])
    pooled = jnp.stack(outs, axis=2).astype(u.dtype)
    y = jnp.einsum('bsgc,gcd->bsgd', pooled, pool_w)
    return y.reshape(B, S, POOL_WIDTH) * pool_scale


def hybrid_layer(x, w_in, w_out, conv_w, pool_w, pool_scale,
                 g_pre_mix, g_post_mix, g_pre_ffn, g_post_ffn, w_gate, w_up, w_down):
    B, S, _ = x.shape
    h = rms_norm(x, g_pre_mix)
    proj = h @ w_in
    offs = np.cumsum([ATTN_WIDTH, ATTN_WIDTH, ATTN_WIDTH, CONV_WIDTH, CONV_WIDTH, CONV_WIDTH]).tolist()
    q, k, v, h_conv, b_gate, c_gate, u_pool = jnp.split(proj, offs, axis=-1)
    to_heads = lambda a: a.reshape(B, S, ATTN_HEADS, HEAD_DIM).transpose(0, 2, 1, 3)
    attn = moba_attention(to_heads(q), to_heads(k), to_heads(v))
    conv = short_conv_mixer(h_conv, b_gate, c_gate, conv_w)
    pool = pool_mixer(u_pool, pool_w, pool_scale)
    mixed = jnp.concatenate([attn, conv, pool], axis=-1) @ w_out
    x = x + rms_norm(mixed, g_post_mix)
    hf = rms_norm(x, g_pre_ffn)
    ff = (jax.nn.silu(hf @ w_gate) * (hf @ w_up)) @ w_down
    return x + rms_norm(ff, g_post_ffn)


def setup_inputs(seed: int = 0) -> dict:
    key = jax.random.key(seed)
    ks = jax.random.split(key, 14)
    f32 = jnp.float32
    nrm = lambda k, shape, s: jax.random.normal(k, shape, f32) * s
    gain = lambda k: 1.0 + 0.05 * jax.random.normal(k, (DEPTH, D_MODEL), f32)
    return {
        "x": jax.random.normal(ks[0], (BATCH, SEQ, D_MODEL), f32),
        "w_in": nrm(ks[1], (DEPTH, D_MODEL, IN_WIDTH), D_MODEL ** -0.5),
        "w_out": nrm(ks[2], (DEPTH, MIX_WIDTH, D_MODEL), MIX_WIDTH ** -0.5),
        "conv_w": nrm(ks[3], (DEPTH, CONV_K, CONV_WIDTH), CONV_K ** -0.5),
        "pool_w": nrm(ks[4], (DEPTH, POOL_GROUPS, POOL_GROUP_DIM, POOL_GROUP_DIM), POOL_GROUP_DIM ** -0.5),
        "pool_scale": 1.0 + 0.1 * jax.random.normal(ks[5], (DEPTH, POOL_WIDTH), f32),
        "g_pre_mix": gain(ks[6]),
        "g_post_mix": gain(ks[7]),
        "g_pre_ffn": gain(ks[8]),
        "g_post_ffn": gain(ks[9]),
        "w_gate": nrm(ks[10], (DEPTH, D_MODEL, D_FF), D_MODEL ** -0.5),
        "w_up": nrm(ks[11], (DEPTH, D_MODEL, D_FF), D_MODEL ** -0.5),
        "w_down": nrm(ks[12], (DEPTH, D_FF, D_MODEL), D_FF ** -0.5),
    }


def reference(x, w_in, w_out, conv_w, pool_w, pool_scale,
              g_pre_mix, g_post_mix, g_pre_ffn, g_post_ffn, w_gate, w_up, w_down):
    for l in range(DEPTH):
        x = hybrid_layer(x, w_in[l], w_out[l], conv_w[l], pool_w[l], pool_scale[l],
                         g_pre_mix[l], g_post_mix[l], g_pre_ffn[l], g_post_ffn[l],
                         w_gate[l], w_up[l], w_down[l])
    return x
```

```cpp
#include <hip/hip_runtime.h>
#include <cstdint>
#include <cstdio>

namespace {
constexpr int D = 1024, BATCH = 8, SEQ = 2048, DEPTH = 2, M = BATCH * SEQ;
constexpr int NH = 8, HD = 64, INW = 2560, FF = 2816, NBLK = 8, MB = 256;
constexpr int OFF_Q = 0, OFF_K = 512, OFF_V = 1024, OFF_HC = 1536, OFF_BG = 1792, OFF_CG = 2048, OFF_UP = 2304;
constexpr float EPS = 1e-6f;

__device__ __forceinline__ float wave_sum(float v) {
#pragma unroll
    for (int o = 1; o < 64; o <<= 1) v += __shfl_xor(v, o);
    return v;
}
__device__ __forceinline__ float wave_max(float v) {
#pragma unroll
    for (int o = 1; o < 64; o <<= 1) v = fmaxf(v, __shfl_xor(v, o));
    return v;
}

__global__ void __launch_bounds__(256) k_norm(const float* __restrict__ x, const float* __restrict__ g, float* __restrict__ out) {
    const int row = blockIdx.x * 4 + (threadIdx.x >> 6), lane = threadIdx.x & 63;
    const float4* xr = (const float4*)(x + (size_t)row * D);
    float4 v[4]; float s = 0.f;
#pragma unroll
    for (int j = 0; j < 4; ++j) { v[j] = xr[lane + 64 * j]; s += v[j].x * v[j].x + v[j].y * v[j].y + v[j].z * v[j].z + v[j].w * v[j].w; }
    const float r = rsqrtf(wave_sum(s) * (1.f / D) + EPS);
    float4* o = (float4*)(out + (size_t)row * D); const float4* g4 = (const float4*)g;
#pragma unroll
    for (int j = 0; j < 4; ++j) { const float4 gg = g4[lane + 64 * j]; float4 w; w.x = v[j].x * r * gg.x; w.y = v[j].y * r * gg.y; w.z = v[j].z * r * gg.z; w.w = v[j].w * r * gg.w; o[lane + 64 * j] = w; }
}
__global__ void __launch_bounds__(256) k_resnorm(float* __restrict__ x, const float* __restrict__ y, const float* __restrict__ g) {
    const int row = blockIdx.x * 4 + (threadIdx.x >> 6), lane = threadIdx.x & 63;
    const float4* yr = (const float4*)(y + (size_t)row * D);
    float4 v[4]; float s = 0.f;
#pragma unroll
    for (int j = 0; j < 4; ++j) { v[j] = yr[lane + 64 * j]; s += v[j].x * v[j].x + v[j].y * v[j].y + v[j].z * v[j].z + v[j].w * v[j].w; }
    const float r = rsqrtf(wave_sum(s) * (1.f / D) + EPS);
    float4* o = (float4*)(x + (size_t)row * D); const float4* g4 = (const float4*)g;
#pragma unroll
    for (int j = 0; j < 4; ++j) { const float4 gg = g4[lane + 64 * j]; float4 w = o[lane + 64 * j]; w.x += v[j].x * r * gg.x; w.y += v[j].y * r * gg.y; w.z += v[j].z * r * gg.z; w.w += v[j].w * r * gg.w; o[lane + 64 * j] = w; }
}

template <int MODE>
__global__ void __launch_bounds__(256) k_gemm(const float* __restrict__ A, const float* __restrict__ B, float* C, int Mm, int N, int K) {
    __shared__ float As[16][64 + 4];
    __shared__ float Bs[16][64 + 4];
    const int tx = threadIdx.x & 15, ty = threadIdx.x >> 4;
    const int m0 = blockIdx.y * 64, n0 = blockIdx.x * 64;
    float acc[4][4] = {};
    for (int k0 = 0; k0 < K; k0 += 16) {
        {
            const int r = threadIdx.x >> 2, c4 = (threadIdx.x & 3) * 4;
            const float4 a = *(const float4*)(A + (size_t)(m0 + r) * K + k0 + c4);
            As[c4 + 0][r] = a.x; As[c4 + 1][r] = a.y; As[c4 + 2][r] = a.z; As[c4 + 3][r] = a.w;
            const int kr = threadIdx.x >> 4, nc = (threadIdx.x & 15) * 4;
            const float4 b = *(const float4*)(B + (size_t)(k0 + kr) * N + n0 + nc);
            *(float4*)&Bs[kr][nc] = b;
        }
        __syncthreads();
#pragma unroll
        for (int k = 0; k < 16; ++k) {
            const float4 a = *(const float4*)&As[k][ty * 4];
            const float4 b = *(const float4*)&Bs[k][tx * 4];
            const float av[4] = {a.x, a.y, a.z, a.w}, bv[4] = {b.x, b.y, b.z, b.w};
#pragma unroll
            for (int i = 0; i < 4; ++i)
#pragma unroll
                for (int j = 0; j < 4; ++j) acc[i][j] = fmaf(av[i], bv[j], acc[i][j]);
        }
        __syncthreads();
    }
#pragma unroll
    for (int i = 0; i < 4; ++i) {
        float4* cp = (float4*)(C + (size_t)(m0 + ty * 4 + i) * N + n0 + tx * 4);
        float4 o = {acc[i][0], acc[i][1], acc[i][2], acc[i][3]};
        if (MODE == 1) { const float4 g = *cp; o.x *= g.x / (1.f + expf(-g.x)); o.y *= g.y / (1.f + expf(-g.y)); o.z *= g.z / (1.f + expf(-g.z)); o.w *= g.w / (1.f + expf(-g.w)); }
        *cp = o;
    }
}

__global__ void __launch_bounds__(256) k_kmean(const float* __restrict__ proj, float* __restrict__ kmean) {
    const int bn = blockIdx.x;
    for (int c = threadIdx.x; c < 512; c += 256) {
        float s = 0.f;
        for (int r = 0; r < MB; ++r) s += proj[(size_t)(bn * MB + r) * INW + OFF_K + c];
        kmean[(size_t)bn * 512 + c] = s * (1.f / MB);
    }
}

__global__ void __launch_bounds__(256) k_attn(const float* __restrict__ proj, const float* __restrict__ kmean, float* __restrict__ mixed) {
    __shared__ float sp[4][1024];
    __shared__ float sq[4][64];
    const int w = threadIdx.x >> 6, lane = threadIdx.x & 63;
    const int gid = blockIdx.x * 4 + w;
    const int t = gid % SEQ, h = (gid / SEQ) % NH, b = gid / (SEQ * NH);
    const int cur = t / MB;
    const float slope = exp2f(-(float)(h + 1));
    const float* qrow = proj + (size_t)(b * SEQ + t) * INW + OFF_Q + h * HD;
    const float qd = qrow[lane];
    sq[w][lane] = qd;
    float gate[NBLK];
#pragma unroll
    for (int n = 0; n < NBLK; ++n) {
        float g = -INFINITY;
        if (n < cur) g = wave_sum(qd * kmean[(size_t)(b * NBLK + n) * 512 + h * HD + lane]);
        gate[n] = g;
    }
    unsigned selpk = (unsigned)cur; int nsel = 1;
    const int ntop = cur < 3 ? cur : 3;
    unsigned used = 0;
    for (int k = 0; k < 3; ++k) {
        if (k < ntop) {
            int best = -1; float bv = -INFINITY;
#pragma unroll
            for (int n = 0; n < NBLK; ++n) if (n < cur && !((used >> n) & 1u) && (best < 0 || gate[n] > bv)) { best = n; bv = gate[n]; }
            used |= 1u << best; selpk |= (unsigned)best << (4 * nsel); ++nsel;
        }
    }
    __syncthreads();
    float mx = -INFINITY;
    for (int i = 0; i < nsel; ++i) {
        const int blk = (int)((selpk >> (4 * i)) & 15u);
        for (int j = 0; j < 4; ++j) {
            const int s = blk * MB + j * 64 + lane;
            float lg = -INFINITY;
            if (s <= t) {
                const float4* kr = (const float4*)(proj + (size_t)(b * SEQ + s) * INW + OFF_K + h * HD);
                float dsum = 0.f;
#pragma unroll
                for (int d4 = 0; d4 < 16; ++d4) { const float4 kv = kr[d4]; dsum += sq[w][d4 * 4] * kv.x + sq[w][d4 * 4 + 1] * kv.y + sq[w][d4 * 4 + 2] * kv.z + sq[w][d4 * 4 + 3] * kv.w; }
                lg = dsum * 0.125f - slope * (float)(t - s);
            }
            sp[w][i * 256 + j * 64 + lane] = lg;
            mx = fmaxf(mx, lg);
        }
    }
    mx = wave_max(mx);
    float sum = 0.f;
    for (int i = 0; i < nsel * 4; ++i) { const float p = expf(sp[w][i * 64 + lane] - mx); sp[w][i * 64 + lane] = p; sum += p; }
    sum = wave_sum(sum);
    __syncthreads();
    float o = 0.f;
    for (int i = 0; i < nsel; ++i) {
        const int blk = (int)((selpk >> (4 * i)) & 15u);
        const float* vb = proj + (size_t)(b * SEQ + blk * MB) * INW + OFF_V + h * HD + lane;
        for (int r = 0; r < MB; ++r) { const float p = sp[w][i * 256 + r]; o = fmaf(p, vb[(size_t)r * INW], o); }
    }
    mixed[(size_t)(b * SEQ + t) * D + h * HD + lane] = o / sum;
}

__global__ void __launch_bounds__(256) k_convpool(const float* __restrict__ proj, const float* __restrict__ conv_w, const float* __restrict__ pool_w,
                                                  const float* __restrict__ pool_scale, float* __restrict__ mixed) {
    __shared__ float pl[256];
    const int row = blockIdx.x, t = row % SEQ, c = threadIdx.x;
    const float* pr = proj + (size_t)row * INW;
    float cv = 0.f;
#pragma unroll
    for (int j = 0; j < 3; ++j) { const int tt = t - 2 + j; if (tt >= 0) { const float* p2 = pr - (size_t)(2 - j) * INW; cv += p2[OFF_CG + c] * p2[OFF_HC + c] * conv_w[j * 256 + c]; } }
    mixed[(size_t)row * D + 512 + c] = pr[OFF_BG + c] * cv;
    const int g = c >> 6, wdw = 2 << g;
    float s = 0.f; int cnt = 0;
    for (int j = 0; j < wdw; ++j) { if (t - j >= 0) { s += (pr - (size_t)j * INW)[OFF_UP + c]; ++cnt; } }
    pl[c] = s / (float)cnt - pr[OFF_UP + c];
    __syncthreads();
    const int d = c & 63; float y = 0.f;
    for (int cc = 0; cc < 64; ++cc) y = fmaf(pl[g * 64 + cc], pool_w[(size_t)(g * 64 + cc) * 64 + d], y);
    mixed[(size_t)row * D + 768 + c] = y * pool_scale[c];
}
}

extern "C" void kernel_launch(void* const* d_in, const int* in_sizes, int n_in, void* d_out, int out_size, void* d_ws, size_t ws_size, hipStream_t stream) {
    const float* x = (const float*)d_in[0]; const float* w_in = (const float*)d_in[1]; const float* w_out = (const float*)d_in[2];
    const float* conv_w = (const float*)d_in[3]; const float* pool_w = (const float*)d_in[4]; const float* pool_scale = (const float*)d_in[5];
    const float* g_pre_mix = (const float*)d_in[6]; const float* g_post_mix = (const float*)d_in[7]; const float* g_pre_ffn = (const float*)d_in[8]; const float* g_post_ffn = (const float*)d_in[9];
    const float* w_gate = (const float*)d_in[10]; const float* w_up = (const float*)d_in[11]; const float* w_down = (const float*)d_in[12];
    float* xc = (float*)d_out;
    char* ws = (char*)d_ws;
    float* RA = (float*)ws;
    float* RB = (float*)(ws + ((size_t)64 << 20));
    float* KM = (float*)(ws + ((size_t)240 << 20));
    hipMemcpyAsync(xc, x, (size_t)M * D * 4, hipMemcpyDeviceToDevice, stream);
    for (int l = 0; l < DEPTH; ++l) {
        k_norm<<<M / 4, 256, 0, stream>>>(xc, g_pre_mix + l * D, RA);
        k_gemm<0><<<dim3(INW / 64, M / 64), 256, 0, stream>>>(RA, w_in + (size_t)l * D * INW, RB, M, INW, D);
        k_kmean<<<BATCH * NBLK, 256, 0, stream>>>(RB, KM);
        k_attn<<<BATCH * NH * SEQ / 4, 256, 0, stream>>>(RB, KM, RA);
        k_convpool<<<M, 256, 0, stream>>>(RB, conv_w + l * 3 * 256, pool_w + (size_t)l * 4 * 64 * 64, pool_scale + l * 256, RA);
        k_gemm<0><<<dim3(D / 64, M / 64), 256, 0, stream>>>(RA, w_out + (size_t)l * D * D, RB, M, D, D);
        k_resnorm<<<M / 4, 256, 0, stream>>>(xc, RB, g_post_mix + l * D);
        k_norm<<<M / 4, 256, 0, stream>>>(xc, g_pre_ffn + l * D, RA);
        k_gemm<0><<<dim3(FF / 64, M / 64), 256, 0, stream>>>(RA, w_gate + (size_t)l * D * FF, RB, M, FF, D);
        k_gemm<1><<<dim3(FF / 64, M / 64), 256, 0, stream>>>(RA, w_up + (size_t)l * D * FF, RB, M, FF, D);
        k_gemm<0><<<dim3(D / 64, M / 64), 256, 0, stream>>>(RB, w_down + (size_t)l * FF * D, RA, M, D, FF);
        k_resnorm<<<M / 4, 256, 0, stream>>>(xc, RA, g_post_ffn + l * D);
    }
}
```
